# Optimizing an MI355X kernel written in HIP

```python
import math
import jax, jax.numpy as jnp
from jax import lax
import numpy as np

D_MODEL = 1024
BATCH = 16
SEQ = 4096
DEPTH = 4

MIX_WIDTH = D_MODEL
A_WIDTH = MIX_WIDTH // 2
A_GROUPS = 8
A_GROUP_DIM = A_WIDTH // A_GROUPS
CHUNK = 128
B_HEADS = 8
HEAD_DIM = 64
B_KV_HEADS = 2
B_GROUP = B_HEADS // B_KV_HEADS
B_WIDTH = B_HEADS * HEAD_DIM
KV_WIDTH = B_KV_HEADS * HEAD_DIM
WINDOW = 128
BLOCK = 128
REL_BUCKETS = 32
REL_MAX_DIST = 128
NORM_EPS = 1e-6
IN_WIDTH = 3 * A_WIDTH + 2 * B_WIDTH + 2 * KV_WIDTH

kernel_name = "hybrid_gmlp_swa_sink_sandwich"


def rms_norm(x, g):
    xf = x.astype(jnp.float32)
    y = xf * lax.rsqrt(jnp.mean(xf * xf, axis=-1, keepdims=True) + NORM_EPS)
    return (y * g.astype(jnp.float32)).astype(x.dtype)


def layer_norm(x, g, b):
    xf = x.astype(jnp.float32)
    mu = jnp.mean(xf, axis=-1, keepdims=True)
    xc = xf - mu
    y = xc * lax.rsqrt(jnp.mean(xc * xc, axis=-1, keepdims=True) + NORM_EPS)
    return (y * g.astype(jnp.float32) + b.astype(jnp.float32)).astype(x.dtype)


def t5_bucket(dist):
    max_exact = REL_BUCKETS // 2
    safe = jnp.maximum(dist, 1).astype(jnp.float32)
    large = max_exact + (jnp.log(safe / max_exact) / math.log(REL_MAX_DIST / max_exact)
                         * (REL_BUCKETS - max_exact)).astype(jnp.int32)
    large = jnp.minimum(large, REL_BUCKETS - 1)
    return jnp.where(dist < max_exact, dist, large)


def chunked_spatial_gating(u, v, ln_g, ln_b, w_s, b_s):
    bsz, seq, _ = v.shape
    n_chunks = seq // CHUNK
    vn = layer_norm(v, ln_g, ln_b).reshape(bsz, n_chunks, CHUNK, A_GROUPS, A_GROUP_DIM)
    causal = jnp.tril(jnp.ones((CHUNK, CHUNK), dtype=bool))
    w = jnp.where(causal[None], w_s, jnp.zeros_like(w_s))
    mixed = jnp.einsum('hij,bcjhd->bcihd', w, vn) + b_s.T[None, None, :, :, None]
    return u * mixed.reshape(bsz, seq, A_WIDTH)


def sliding_window_sink_attention(q, k, v, sinks, rel_bias):
    bsz, seq = q.shape[0], q.shape[1]
    nb = seq // BLOCK
    qb = q.reshape(bsz, nb, BLOCK, B_KV_HEADS, B_GROUP, HEAD_DIM)
    pad = jnp.zeros((bsz, BLOCK, B_KV_HEADS, HEAD_DIM), k.dtype)
    kp = jnp.concatenate([pad, k], axis=1).reshape(bsz, nb + 1, BLOCK, B_KV_HEADS, HEAD_DIM)
    vp = jnp.concatenate([pad, v], axis=1).reshape(bsz, nb + 1, BLOCK, B_KV_HEADS, HEAD_DIM)
    kb = jnp.concatenate([kp[:, :-1], kp[:, 1:]], axis=2)
    vb = jnp.concatenate([vp[:, :-1], vp[:, 1:]], axis=2)

    logits = jnp.einsum('bnqkgd,bnskd->bnkgqs', qb, kb).astype(jnp.float32) * (HEAD_DIM ** -0.5)

    q_loc = jnp.arange(BLOCK)[:, None]
    k_loc = jnp.arange(2 * BLOCK)[None, :]
    dist = q_loc + BLOCK - k_loc
    in_window = (dist >= 0) & (dist < WINDOW)
    key_pos = (jnp.arange(nb)[:, None] - 1) * BLOCK + jnp.arange(2 * BLOCK)[None, :]
    mask = in_window[None] & (key_pos >= 0)[:, None, :]

    bias = rel_bias.astype(jnp.float32)[t5_bucket(jnp.maximum(dist, 0))]
    bias = bias.transpose(2, 0, 1).reshape(B_KV_HEADS, B_GROUP, BLOCK, 2 * BLOCK)
    logits = jnp.where(mask[None, :, None, None], logits + bias, jnp.float32(-1e30))

    sink = sinks.astype(jnp.float32).reshape(B_KV_HEADS, B_GROUP)[None, None, :, :, None, None]
    m = jnp.maximum(jnp.max(logits, axis=-1, keepdims=True), sink)
    e = jnp.exp(logits - m)
    probs = e / (jnp.sum(e, axis=-1, keepdims=True) + jnp.exp(sink - m))
    out = jnp.einsum('bnkgqs,bnskd->bnqkgd', probs.astype(vb.dtype), vb)
    return out.reshape(bsz, seq, B_WIDTH)


def hybrid_layer(x, pre_g, w_in, ln_g, ln_b, w_s, b_s, sinks, rel_bias, w_out, post_g):
    bsz, seq, _ = x.shape
    h = rms_norm(x, pre_g)
    proj = h @ w_in
    splits = [2 * A_WIDTH, 3 * A_WIDTH, 3 * A_WIDTH + B_WIDTH,
              3 * A_WIDTH + B_WIDTH + KV_WIDTH, 3 * A_WIDTH + B_WIDTH + 2 * KV_WIDTH]
    a_uv, a_z, q, k, v, b_z = jnp.split(proj, splits, axis=-1)

    a_uv = jax.nn.gelu(a_uv)
    u, vv = jnp.split(a_uv, 2, axis=-1)
    y_a = chunked_spatial_gating(u, vv, ln_g, ln_b, w_s, b_s) * jax.nn.silu(a_z)

    q = q.reshape(bsz, seq, B_HEADS, HEAD_DIM)
    k = k.reshape(bsz, seq, B_KV_HEADS, HEAD_DIM)
    v = v.reshape(bsz, seq, B_KV_HEADS, HEAD_DIM)
    y_b = sliding_window_sink_attention(q, k, v, sinks, rel_bias) * jax.nn.silu(b_z)

    y = jnp.concatenate([y_a, y_b], axis=-1) @ w_out
    return x + rms_norm(y, post_g)


def setup_inputs(seed: int = 0) -> dict:
    key = jax.random.key(seed)
    ks = jax.random.split(key, 12)
    f32 = jnp.float32
    x = jax.random.normal(ks[0], (BATCH, SEQ, D_MODEL), f32)
    pre_norm_g = 1.0 + 0.05 * jax.random.normal(ks[1], (DEPTH, D_MODEL), f32)
    w_in = jax.random.normal(ks[2], (DEPTH, D_MODEL, IN_WIDTH), f32) * (D_MODEL ** -0.5)
    ln_v_g = 1.0 + 0.05 * jax.random.normal(ks[3], (DEPTH, A_WIDTH), f32)
    ln_v_b = 0.02 * jax.random.normal(ks[4], (DEPTH, A_WIDTH), f32)
    w_spatial = jax.random.normal(ks[5], (DEPTH, A_GROUPS, CHUNK, CHUNK), f32) * (CHUNK ** -0.5)
    b_spatial = 1.0 + 0.1 * jax.random.normal(ks[6], (DEPTH, A_GROUPS, CHUNK), f32)
    sinks = 0.5 * jax.random.normal(ks[7], (DEPTH, B_HEADS), f32)
    rel_bias = 0.5 * jax.random.normal(ks[8], (REL_BUCKETS, B_HEADS), f32)
    w_out = jax.random.normal(ks[9], (DEPTH, MIX_WIDTH, D_MODEL), f32) * (MIX_WIDTH ** -0.5)
    post_norm_g = 1.0 + 0.05 * jax.random.normal(ks[10], (DEPTH, D_MODEL), f32)
    return {"x": x, "pre_norm_g": pre_norm_g, "w_in": w_in, "ln_v_g": ln_v_g, "ln_v_b": ln_v_b,
            "w_spatial": w_spatial, "b_spatial": b_spatial, "sinks": sinks, "rel_bias": rel_bias,
            "w_out": w_out, "post_norm_g": post_norm_g}


def reference(x, pre_norm_g, w_in, ln_v_g, ln_v_b, w_spatial, b_spatial, sinks, rel_bias,
              w_out, post_norm_g):
    for layer in range(DEPTH):
        x = hybrid_layer(x, pre_norm_g[layer], w_in[layer], ln_v_g[layer], ln_v_b[layer],
                         w_spatial[layer], b_spatial[layer], sinks[layer], rel_bias,
                         w_out[layer], post_norm_g[layer])
    return x
```

```cpp
#include <hip/hip_runtime.h>
#include <cstdint>
#include <cstdio>

namespace gold {
constexpr int D = 1024, BATCH = 16, SEQ = 4096, DEPTH = 4;
constexpr int AW = 512, NG = 8, GD = 64, CH = 128, NH = 8, HD = 64, NKV = 2, BW = 512, KVW = 128, INW = 2816;
constexpr int C_U = 0, C_V = 512, C_AZ = 1024, C_Q = 1536, C_K = 2048, C_VV = 2176, C_BZ = 2304;
constexpr float EPS = 1e-6f;

__device__ __forceinline__ float gelu_tanh(float x) { return 0.5f * x * (1.f + tanhf(0.7978845608028654f * (x + 0.044715f * x * x * x))); }
__device__ __forceinline__ float silu(float x) { return x / (1.f + __expf(-x)); }
__device__ __forceinline__ float wave_sum(float v) {
#pragma unroll
    for (int o = 1; o < 64; o <<= 1) v += __shfl_xor(v, o);
    return v;
}

__global__ void __launch_bounds__(256) k_rmsnorm(const float* __restrict__ x, const float* __restrict__ g, float* __restrict__ h, int rows) {
    const int row = blockIdx.x * 4 + (threadIdx.x >> 6), lane = threadIdx.x & 63;
    if (row >= rows) return;
    const float4* xr = (const float4*)(x + (size_t)row * D);
    float4 v[4]; float s = 0.f;
#pragma unroll
    for (int j = 0; j < 4; ++j) { v[j] = xr[lane + 64 * j]; s += v[j].x * v[j].x + v[j].y * v[j].y + v[j].z * v[j].z + v[j].w * v[j].w; }
    const float r = rsqrtf(wave_sum(s) * (1.f / D) + EPS);
    float4* hr = (float4*)(h + (size_t)row * D);
#pragma unroll
    for (int j = 0; j < 4; ++j) { const float4 gg = ((const float4*)g)[lane + 64 * j]; hr[lane + 64 * j] = make_float4(v[j].x * r * gg.x, v[j].y * r * gg.y, v[j].z * r * gg.z, v[j].w * r * gg.w); }
}

__global__ void __launch_bounds__(256) k_sgemm(const float* __restrict__ A, const float* __restrict__ B, float* __restrict__ C, int M, int N, int K) {
    __shared__ float As[16][128 + 4];
    __shared__ float Bs[16][128 + 4];
    const int tid = threadIdx.x, tx = tid & 15, ty = tid >> 4;
    const int m0 = blockIdx.y * 128, n0 = blockIdx.x * 128;
    float acc[8][8];
#pragma unroll
    for (int i = 0; i < 8; ++i)
#pragma unroll
        for (int j = 0; j < 8; ++j) acc[i][j] = 0.f;
    for (int k0 = 0; k0 < K; k0 += 16) {
#pragma unroll
        for (int i = 0; i < 2; ++i) { const int idx = tid + i * 256, r = idx >> 2, c4 = idx & 3;
            const float4 a = *(const float4*)(A + (size_t)(m0 + r) * K + k0 + c4 * 4);
            As[c4 * 4 + 0][r] = a.x; As[c4 * 4 + 1][r] = a.y; As[c4 * 4 + 2][r] = a.z; As[c4 * 4 + 3][r] = a.w; }
#pragma unroll
        for (int i = 0; i < 2; ++i) { const int idx = tid + i * 256, r = idx >> 5, c4 = idx & 31;
            *(float4*)&Bs[r][c4 * 4] = *(const float4*)(B + (size_t)(k0 + r) * N + n0 + c4 * 4); }
        __syncthreads();
#pragma unroll
        for (int kk = 0; kk < 16; ++kk) {
            float a[8], b[8];
            *(float4*)&a[0] = *(const float4*)&As[kk][ty * 4]; *(float4*)&a[4] = *(const float4*)&As[kk][64 + ty * 4];
            *(float4*)&b[0] = *(const float4*)&Bs[kk][tx * 4]; *(float4*)&b[4] = *(const float4*)&Bs[kk][64 + tx * 4];
#pragma unroll
            for (int i = 0; i < 8; ++i)
#pragma unroll
                for (int j = 0; j < 8; ++j) acc[i][j] = fmaf(a[i], b[j], acc[i][j]);
        }
        __syncthreads();
    }
#pragma unroll
    for (int i = 0; i < 8; ++i) { const int r = m0 + (i < 4 ? ty * 4 + i : 64 + ty * 4 + (i - 4));
        *(float4*)(C + (size_t)r * N + n0 + tx * 4) = make_float4(acc[i][0], acc[i][1], acc[i][2], acc[i][3]);
        *(float4*)(C + (size_t)r * N + n0 + 64 + tx * 4) = make_float4(acc[i][4], acc[i][5], acc[i][6], acc[i][7]); }
}

__global__ void __launch_bounds__(256) k_gmlp_pre(float* __restrict__ proj, const float* __restrict__ lng, const float* __restrict__ lnb, int rows) {
    const int row = blockIdx.x * 4 + (threadIdx.x >> 6), lane = threadIdx.x & 63;
    if (row >= rows) return;
    float* p = proj + (size_t)row * INW;
    float u[8], v[8]; float s = 0.f;
#pragma unroll
    for (int j = 0; j < 8; ++j) { u[j] = gelu_tanh(p[C_U + lane + 64 * j]); v[j] = gelu_tanh(p[C_V + lane + 64 * j]); s += v[j]; }
    const float mu = wave_sum(s) * (1.f / AW); float q = 0.f;
#pragma unroll
    for (int j = 0; j < 8; ++j) { v[j] -= mu; q += v[j] * v[j]; }
    const float r = rsqrtf(wave_sum(q) * (1.f / AW) + EPS);
#pragma unroll
    for (int j = 0; j < 8; ++j) { p[C_U + lane + 64 * j] = u[j]; p[C_V + lane + 64 * j] = v[j] * r * lng[lane + 64 * j] + lnb[lane + 64 * j]; }
}

__global__ void __launch_bounds__(256) k_gmlp_mix(const float* __restrict__ proj, const float* __restrict__ ws_, const float* __restrict__ bs, float* __restrict__ ycat) {
    __shared__ float vn[128][64];
    const int chunk = blockIdx.x, h = blockIdx.y, tid = threadIdx.x;
    const size_t row0 = (size_t)chunk * CH;
    for (int idx = tid; idx < 128 * 64; idx += 256) { const int j = idx >> 6, d = idx & 63; vn[j][d] = proj[(row0 + j) * INW + C_V + h * 64 + d]; }
    __syncthreads();
    const int d = tid & 63, ig = tid >> 6;
    const float* W = ws_ + (size_t)h * CH * CH;
    for (int i = ig; i < 128; i += 4) {
        float acc = 0.f;
        for (int j = 0; j <= i; ++j) acc = fmaf(W[i * CH + j], vn[j][d], acc);
        acc += bs[h * CH + i];
        const float* p = proj + (row0 + i) * INW;
        ycat[(row0 + i) * D + h * 64 + d] = p[C_U + h * 64 + d] * acc * silu(p[C_AZ + h * 64 + d]);
    }
}

__global__ void __launch_bounds__(128) k_attn(const float* __restrict__ proj, const float* __restrict__ sinks, const float* __restrict__ relb, float* __restrict__ ycat) {
    __shared__ float Ks[64][64];
    __shared__ float Vs[64][64];
    __shared__ float biasd[128];
    const int nb = blockIdx.x, hq = blockIdx.y, kv = hq >> 2, t = threadIdx.x;
    const size_t row0 = (size_t)nb * 128;
    const int pos0 = (int)(row0 % SEQ);
    {
        const int dist = t; int bucket;
        if (dist < 16) bucket = dist; else { const float sf = (float)dist; int lg = 16 + (int)(logf(sf / 16.f) / 2.0794415416798357f * 16.f); bucket = lg < 31 ? lg : 31; }
        biasd[t] = relb[bucket * NH + hq];
    }
    float q[64];
    { const float* qp = proj + (row0 + t) * INW + C_Q + hq * 64;
#pragma unroll
      for (int d = 0; d < 64; ++d) q[d] = qp[d]; }
    const float sink = sinks[hq];
    float m = sink, l = 1.f;
    float o[64];
#pragma unroll
    for (int d = 0; d < 64; ++d) o[d] = 0.f;
    for (int tile = 0; tile < 4; ++tile) {
        const int kpos0 = pos0 - 128 + tile * 64;
        __syncthreads();
        for (int idx = t; idx < 64 * 64; idx += 128) { const int kk = idx >> 6, d = idx & 63; const int kp = kpos0 + kk;
            float kvv = 0.f, vvv = 0.f;
            if (kp >= 0) { const float* pr = proj + (row0 - 128 + tile * 64 + kk) * INW; kvv = pr[C_K + kv * 64 + d]; vvv = pr[C_VV + kv * 64 + d]; }
            Ks[kk][d] = kvv; Vs[kk][d] = vvv; }
        __syncthreads();
        for (int kk = 0; kk < 64; ++kk) {
            const int kp = kpos0 + kk; const int dist = (pos0 + t) - kp;
            if (dist < 0 || dist >= 128 || kp < 0) continue;
            float s = 0.f;
#pragma unroll
            for (int d = 0; d < 64; ++d) s = fmaf(q[d], Ks[kk][d], s);
            s = s * 0.125f + biasd[dist];
            if (s > m) { const float f = __expf(m - s); l *= f;
#pragma unroll
                for (int d = 0; d < 64; ++d) o[d] *= f;
                m = s; }
            const float e = __expf(s - m); l += e;
#pragma unroll
            for (int d = 0; d < 64; ++d) o[d] = fmaf(e, Vs[kk][d], o[d]);
        }
    }
    const float inv = 1.f / l;
    const float* bz = proj + (row0 + t) * INW + C_BZ + hq * 64;
    float* yo = ycat + (row0 + t) * D + AW + hq * 64;
#pragma unroll
    for (int d = 0; d < 64; ++d) yo[d] = o[d] * inv * silu(bz[d]);
}

__global__ void __launch_bounds__(256) k_post(float* __restrict__ x, const float* __restrict__ y, const float* __restrict__ g, int rows) {
    const int row = blockIdx.x * 4 + (threadIdx.x >> 6), lane = threadIdx.x & 63;
    if (row >= rows) return;
    const float4* yr = (const float4*)(y + (size_t)row * D);
    float4 v[4]; float s = 0.f;
#pragma unroll
    for (int j = 0; j < 4; ++j) { v[j] = yr[lane + 64 * j]; s += v[j].x * v[j].x + v[j].y * v[j].y + v[j].z * v[j].z + v[j].w * v[j].w; }
    const float r = rsqrtf(wave_sum(s) * (1.f / D) + EPS);
    float4* xr = (float4*)(x + (size_t)row * D);
#pragma unroll
    for (int j = 0; j < 4; ++j) { const float4 gg = ((const float4*)g)[lane + 64 * j]; float4 xv = xr[lane + 64 * j];
        xv.x += v[j].x * r * gg.x; xv.y += v[j].y * r * gg.y; xv.z += v[j].z * r * gg.z; xv.w += v[j].w * r * gg.w; xr[lane + 64 * j] = xv; }
}

static void forward_slice(float* x, int rows, int l0, int l1, void* const* d_in, float* scratch, hipStream_t stream) {
    const float* pre_g = (const float*)d_in[1]; const float* w_in = (const float*)d_in[2]; const float* ln_g = (const float*)d_in[3]; const float* ln_b = (const float*)d_in[4];
    const float* w_sp = (const float*)d_in[5]; const float* b_sp = (const float*)d_in[6]; const float* sinks = (const float*)d_in[7]; const float* relb = (const float*)d_in[8];
    const float* w_out = (const float*)d_in[9]; const float* post_g = (const float*)d_in[10];
    float* h = scratch; float* proj = h + (size_t)rows * D; float* ycat = proj + (size_t)rows * INW; float* y = ycat + (size_t)rows * D;
    for (int l = l0; l < l1; ++l) {
        k_rmsnorm<<<rows / 4, 256, 0, stream>>>(x, pre_g + (size_t)l * D, h, rows);
        k_sgemm<<<dim3(INW / 128, rows / 128), 256, 0, stream>>>(h, w_in + (size_t)l * D * INW, proj, rows, INW, D);
        k_gmlp_pre<<<rows / 4, 256, 0, stream>>>(proj, ln_g + (size_t)l * AW, ln_b + (size_t)l * AW, rows);
        k_gmlp_mix<<<dim3(rows / CH, NG), 256, 0, stream>>>(proj, w_sp + (size_t)l * NG * CH * CH, b_sp + (size_t)l * NG * CH, ycat);
        k_attn<<<dim3(rows / 128, NH), 128, 0, stream>>>(proj, sinks + (size_t)l * NH, relb, ycat);
        k_sgemm<<<dim3(D / 128, rows / 128), 256, 0, stream>>>(ycat, w_out + (size_t)l * D * D, y, rows, D, D);
        k_post<<<rows / 4, 256, 0, stream>>>(x, y, post_g + (size_t)l * D, rows);
    }
}
}

extern "C" void kernel_launch(void* const* d_in, const int* in_sizes, int n_in, void* d_out, int out_size, void* d_ws, size_t ws_size, hipStream_t stream) {
    using namespace gold;
    float* out = (float*)d_out;
    hipMemcpyAsync(out, d_in[0], (size_t)BATCH * SEQ * D * sizeof(float), hipMemcpyDeviceToDevice, stream);
    constexpr int SB = 2;
    for (int b = 0; b < BATCH; b += SB)
        forward_slice(out + (size_t)b * SEQ * D, SB * SEQ, 0, DEPTH, d_in, (float*)d_ws, stream);
}
```
